# Optimizing an MI355X kernel written in HIP

```python
import jax, jax.numpy as jnp
from jax import lax
import numpy as np

D_MODEL = 1024
BATCH = 4
SEQ = 4096
DEPTH = 1

GDN_HEADS = 8
GDN_HEAD_DIM = 128
GDN_WIDTH = GDN_HEADS * GDN_HEAD_DIM
CONV_WIDTH = 4
GDN_CHUNK = 64
FOX_HEADS = 16
FOX_HEAD_DIM = 64
FOX_WIDTH = FOX_HEADS * FOX_HEAD_DIM
FOX_BLOCK = 128
D_FF = -(-8 * D_MODEL // (3 * 256)) * 256
EPS = 1e-6

IN_SPLITS = (
    GDN_WIDTH, GDN_WIDTH, GDN_WIDTH,
    GDN_WIDTH,
    GDN_HEADS, GDN_HEADS,
    FOX_WIDTH, FOX_WIDTH, FOX_WIDTH,
    FOX_HEADS,
    FOX_WIDTH,
    D_MODEL, D_MODEL,
)
D_IN = sum(IN_SPLITS)

kernel_name = "hybrid_gdn_fox_gated_merge"


def rms_norm(x, w):
    xf = x.astype(jnp.float32)
    y = xf * lax.rsqrt(jnp.mean(xf * xf, axis=-1, keepdims=True) + EPS)
    return (y * w.astype(jnp.float32)).astype(x.dtype)


def l2_normalize(x):
    xf = x.astype(jnp.float32)
    return xf * lax.rsqrt(jnp.sum(xf * xf, axis=-1, keepdims=True) + EPS)


def causal_depthwise_conv(x, w):
    c = x.shape[-1]
    return lax.conv_general_dilated(
        x, w[:, None, :].astype(x.dtype), window_strides=(1,),
        padding=[(CONV_WIDTH - 1, 0)],
        dimension_numbers=("NWC", "WIO", "NWC"), feature_group_count=c)


def gated_delta_rule_chunked(q, k, v, g, beta):
    b, s, h, dk = q.shape
    dv = v.shape[-1]
    n = s // GDN_CHUNK
    c = GDN_CHUNK

    def chunks(t):
        return t.astype(jnp.float32).reshape(b, n, c, h, -1).transpose(0, 3, 1, 2, 4)

    q = chunks(q) * (dk ** -0.5)
    k = chunks(k)
    v = chunks(v)
    g = g.astype(jnp.float32).reshape(b, n, c, h).transpose(0, 3, 1, 2)
    beta = beta.astype(jnp.float32).reshape(b, n, c, h).transpose(0, 3, 1, 2)
    gc = jnp.cumsum(g, axis=-1)

    tri = jnp.tril(jnp.ones((c, c), dtype=bool))
    strict = jnp.tril(jnp.ones((c, c), dtype=bool), -1)
    diff = gc[..., :, None] - gc[..., None, :]
    decay = jnp.where(tri, jnp.exp(jnp.where(tri, diff, 0.0)), 0.0)

    kb = k * beta[..., None]
    vb = v * beta[..., None]
    lower = jnp.where(strict, jnp.einsum('bhncd,bhnsd->bhncs', kb, k) * decay, 0.0)
    a_mat = lower + jnp.eye(c, dtype=jnp.float32)
    rhs = jnp.concatenate([vb, kb * jnp.exp(gc)[..., None]], axis=-1)
    sol = lax.linalg.triangular_solve(a_mat, rhs, left_side=True, lower=True,
                                      unit_diagonal=True)
    u = sol[..., :dv]
    w = sol[..., dv:]
    qk = jnp.where(tri, jnp.einsum('bhncd,bhnsd->bhncs', q, k) * decay, 0.0)

    def step(state, inp):
        q_n, k_n, u_n, w_n, qk_n, gc_n = inp
        v_new = u_n - jnp.einsum('bhcd,bhde->bhce', w_n, state)
        o = (jnp.einsum('bhcd,bhde->bhce', q_n * jnp.exp(gc_n)[..., None], state)
             + jnp.einsum('bhcs,bhse->bhce', qk_n, v_new))
        g_last = gc_n[..., -1]
        k_dec = k_n * jnp.exp(g_last[..., None] - gc_n)[..., None]
        state = (state * jnp.exp(g_last)[..., None, None]
                 + jnp.einsum('bhcd,bhce->bhde', k_dec, v_new))
        return state, o

    xs = tuple(jnp.moveaxis(t, 2, 0) for t in (q, k, u, w, qk, gc))
    state0 = jnp.zeros((b, h, dk, dv), jnp.float32)
    _, o = lax.scan(step, state0, xs)
    o = jnp.moveaxis(o, 0, 2)
    return o.transpose(0, 2, 3, 1, 4).reshape(b, s, h, dv)


def forgetting_attention(q, k, v, log_f):
    b, s, h, d = q.shape
    nb = s // FOX_BLOCK
    scale = d ** -0.5
    cum = jnp.cumsum(log_f.astype(jnp.float32), axis=1)
    cum_k = cum.transpose(0, 2, 1)
    q_blocks = q.reshape(b, nb, FOX_BLOCK, h, d).transpose(1, 0, 2, 3, 4)
    c_blocks = cum.reshape(b, nb, FOX_BLOCK, h).transpose(1, 0, 3, 2)
    kpos = jnp.arange(s)

    def one_block(args):
        q_i, c_i, i = args
        sc = jnp.einsum('bqhd,bkhd->bhqk', q_i, k).astype(jnp.float32) * scale
        sc = sc + c_i[..., :, None] - cum_k[:, :, None, :]
        qpos = i * FOX_BLOCK + jnp.arange(FOX_BLOCK)
        mask = kpos[None, :] <= qpos[:, None]
        sc = jnp.where(mask, sc, -jnp.inf)
        p = jax.nn.softmax(sc, axis=-1).astype(v.dtype)
        return jnp.einsum('bhqk,bkhd->bqhd', p, v)

    out = lax.map(one_block, (q_blocks, c_blocks, jnp.arange(nb)))
    return out.transpose(1, 0, 2, 3, 4).reshape(b, s, h, d)


def hybrid_mixer(h, w_in, conv_w, a_log, dt_bias, gdn_norm_w, fox_f_bias,
                 w_branch_a, w_branch_b, w_out):
    b, s, _ = h.shape
    proj = h @ w_in
    offs = np.cumsum(np.array(IN_SPLITS))[:-1].tolist()
    (gq, gk, gv, gz, ga, gb, fq, fk, fv, ff, fo, mga, mgb) = jnp.split(proj, offs, axis=-1)

    qkv = jax.nn.silu(causal_depthwise_conv(jnp.concatenate([gq, gk, gv], axis=-1), conv_w))
    cq, ck, cv = jnp.split(qkv, 3, axis=-1)
    cq = l2_normalize(cq.reshape(b, s, GDN_HEADS, GDN_HEAD_DIM))
    ck = l2_normalize(ck.reshape(b, s, GDN_HEADS, GDN_HEAD_DIM))
    cv = cv.reshape(b, s, GDN_HEADS, GDN_HEAD_DIM)
    g = -jnp.exp(a_log.astype(jnp.float32)) * jax.nn.softplus(
        ga.astype(jnp.float32) + dt_bias.astype(jnp.float32))
    beta = jax.nn.sigmoid(gb.astype(jnp.float32))
    o_a = gated_delta_rule_chunked(cq, ck, cv, g, beta)
    o_a = o_a * lax.rsqrt(jnp.mean(o_a * o_a, axis=-1, keepdims=True) + EPS)
    o_a = o_a * gdn_norm_w.astype(jnp.float32) * jax.nn.silu(
        gz.astype(jnp.float32).reshape(b, s, GDN_HEADS, GDN_HEAD_DIM))
    o_a = o_a.reshape(b, s, GDN_WIDTH).astype(h.dtype)

    log_f = jax.nn.log_sigmoid(ff.astype(jnp.float32) + fox_f_bias.astype(jnp.float32))
    o_b = forgetting_attention(fq.reshape(b, s, FOX_HEADS, FOX_HEAD_DIM),
                               fk.reshape(b, s, FOX_HEADS, FOX_HEAD_DIM),
                               fv.reshape(b, s, FOX_HEADS, FOX_HEAD_DIM), log_f)
    o_b = o_b.reshape(b, s, FOX_WIDTH) * jax.nn.sigmoid(fo)

    y = (jax.nn.sigmoid(mga) * (o_a @ w_branch_a)
         + jax.nn.sigmoid(mgb) * (o_b @ w_branch_b))
    return y @ w_out


def swiglu(h, w_gate, w_up, w_down):
    return (jax.nn.silu(h @ w_gate) * (h @ w_up)) @ w_down


def setup_inputs(seed: int = 0) -> dict:
    key = jax.random.key(seed)
    ks = jax.random.split(key, 20)
    f32 = jnp.float32

    def dense(k, fan_in, fan_out):
        return jax.random.normal(k, (DEPTH, fan_in, fan_out), f32) * fan_in ** -0.5

    def gain(k, n):
        return 1.0 + 0.02 * jax.random.normal(k, (DEPTH, n), f32)

    x = jax.random.normal(ks[0], (BATCH, SEQ, D_MODEL), f32)
    dt = jnp.exp(jax.random.uniform(ks[5], (DEPTH, GDN_HEADS), f32,
                                    minval=np.log(1e-3), maxval=np.log(1e-1)))
    return {
        "x": x,
        "norm_mix_w": gain(ks[1], D_MODEL),
        "w_in": dense(ks[2], D_MODEL, D_IN),
        "conv_w": jax.random.normal(ks[3], (DEPTH, CONV_WIDTH, 3 * GDN_WIDTH), f32) * CONV_WIDTH ** -0.5,
        "a_log": jnp.log(jax.random.uniform(ks[4], (DEPTH, GDN_HEADS), f32, minval=1.0, maxval=16.0)),
        "dt_bias": dt + jnp.log(-jnp.expm1(-dt)),
        "gdn_norm_w": gain(ks[6], GDN_HEAD_DIM),
        "fox_f_bias": jax.random.uniform(ks[7], (DEPTH, FOX_HEADS), f32, minval=1.0, maxval=4.0),
        "w_branch_a": dense(ks[8], GDN_WIDTH, D_MODEL),
        "w_branch_b": dense(ks[9], FOX_WIDTH, D_MODEL),
        "w_out": dense(ks[10], D_MODEL, D_MODEL),
        "norm_ffn_w": gain(ks[11], D_MODEL),
        "w_gate": dense(ks[12], D_MODEL, D_FF),
        "w_up": dense(ks[13], D_MODEL, D_FF),
        "w_down": dense(ks[14], D_FF, D_MODEL),
        "norm_final_w": 1.0 + 0.02 * jax.random.normal(ks[15], (D_MODEL,), f32),
    }


def reference(x, norm_mix_w, w_in, conv_w, a_log, dt_bias, gdn_norm_w, fox_f_bias,
              w_branch_a, w_branch_b, w_out, norm_ffn_w, w_gate, w_up, w_down,
              norm_final_w):
    h = x
    for l in range(DEPTH):
        h = h + hybrid_mixer(rms_norm(h, norm_mix_w[l]), w_in[l], conv_w[l], a_log[l],
                             dt_bias[l], gdn_norm_w[l], fox_f_bias[l],
                             w_branch_a[l], w_branch_b[l], w_out[l])
        h = h + swiglu(rms_norm(h, norm_ffn_w[l]), w_gate[l], w_up[l], w_down[l])
    return rms_norm(h, norm_final_w)
```

```cpp
#include <hip/hip_runtime.h>
#include <cstdio>
#include <cstdint>
#include <cmath>

namespace nv {
constexpr int D = 1024, B = 4, S = 4096, GH = 8, GD = 128, FH = 16, FD = 64, FF = 2816, DIN = 10272;
constexpr int OFF_GQ = 0, OFF_GK = 1024, OFF_GV = 2048, OFF_GZ = 3072, OFF_GA = 4096, OFF_GB = 4104, OFF_FQ = 4112, OFF_FK = 5136, OFF_FV = 6160,
              OFF_FF = 7184, OFF_FO = 7200, OFF_MGA = 8224, OFF_MGB = 9248;
constexpr float EPS = 1e-6f;

__device__ __forceinline__ float sigmoidf_(float x) { return 1.f / (1.f + expf(-x)); }
__device__ __forceinline__ float siluf_(float x) { return x / (1.f + expf(-x)); }
__device__ __forceinline__ float softplusf_(float x) { return x > 20.f ? x : log1pf(expf(x)); }
__device__ __forceinline__ float wave_sum(float v) {
#pragma unroll
    for (int o = 1; o < 64; o <<= 1) v += __shfl_xor(v, o);
    return v;
}

__global__ void k_rmsnorm(const float* __restrict__ x, const float* __restrict__ w, float* __restrict__ out, int rows) {
    const int wid = (blockIdx.x * blockDim.x + threadIdx.x) >> 6, lane = threadIdx.x & 63;
    if (wid >= rows) return;
    const float* xr = x + (size_t)wid * D;
    float v[16]; float s = 0.f;
#pragma unroll
    for (int j = 0; j < 16; ++j) { v[j] = xr[lane + 64 * j]; s += v[j] * v[j]; }
    s = wave_sum(s);
    const float r = rsqrtf(s * (1.f / D) + EPS);
#pragma unroll
    for (int j = 0; j < 16; ++j) out[(size_t)wid * D + lane + 64 * j] = v[j] * r * w[lane + 64 * j];
}

template <int MODE>
__global__ void __launch_bounds__(256) k_gemm(const float* __restrict__ A, int lda, const float* __restrict__ Bm, int ldb, float* __restrict__ C, int ldc,
                                              const float* __restrict__ R, int M, int N, int K) {
    __shared__ float As[16][64 + 4];
    __shared__ float Bs[16][64 + 4];
    const int tid = threadIdx.x, tx = tid & 15, ty = tid >> 4;
    const int m0 = blockIdx.y * 64, n0 = blockIdx.x * 64;
    float acc[4][4];
#pragma unroll
    for (int i = 0; i < 4; ++i)
#pragma unroll
        for (int j = 0; j < 4; ++j) acc[i][j] = 0.f;
    for (int k0 = 0; k0 < K; k0 += 16) {
#pragma unroll
        for (int i = 0; i < 4; ++i) { const int e = tid + 256 * i, r = e >> 4, kk = e & 15; As[kk][r] = A[(size_t)(m0 + r) * lda + k0 + kk]; }
#pragma unroll
        for (int i = 0; i < 4; ++i) { const int e = tid + 256 * i, kk = e >> 6, c = e & 63; Bs[kk][c] = (n0 + c < N) ? Bm[(size_t)(k0 + kk) * ldb + n0 + c] : 0.f; }
        __syncthreads();
#pragma unroll
        for (int kk = 0; kk < 16; ++kk) {
            float a[4], b[4];
#pragma unroll
            for (int i = 0; i < 4; ++i) a[i] = As[kk][ty * 4 + i];
#pragma unroll
            for (int j = 0; j < 4; ++j) b[j] = Bs[kk][tx * 4 + j];
#pragma unroll
            for (int i = 0; i < 4; ++i)
#pragma unroll
                for (int j = 0; j < 4; ++j) acc[i][j] = fmaf(a[i], b[j], acc[i][j]);
        }
        __syncthreads();
    }
#pragma unroll
    for (int i = 0; i < 4; ++i)
#pragma unroll
        for (int j = 0; j < 4; ++j) { const int r = m0 + ty * 4 + i, c = n0 + tx * 4 + j; if (c < N) { float v = acc[i][j]; if (MODE == 1) v += R[(size_t)r * ldc + c]; C[(size_t)r * ldc + c] = v; } }
}

__global__ void __launch_bounds__(128) k_gdn_pre(const float* __restrict__ proj, const float* __restrict__ conv_w, const float* __restrict__ a_log, const float* __restrict__ dt_bias,
                                                 float* __restrict__ cq, float* __restrict__ ck, float* __restrict__ cv, float* __restrict__ g, float* __restrict__ beta) {
    const int t = blockIdx.x, h = blockIdx.y, d = threadIdx.x, c = h * GD + d;
    __shared__ float red[2][2];
    float val[3];
#pragma unroll
    for (int p = 0; p < 3; ++p) {
        const int ch = p * 1024 + c; float s = 0.f;
#pragma unroll
        for (int j = 0; j < 4; ++j) { const int tt = t - 3 + j; if (tt >= 0) s += conv_w[j * 3072 + ch] * proj[(size_t)tt * DIN + ch]; }
        val[p] = siluf_(s);
    }
    float sq = wave_sum(val[0] * val[0]), sk = wave_sum(val[1] * val[1]);
    if ((d & 63) == 0) { red[0][d >> 6] = sq; red[1][d >> 6] = sk; }
    __syncthreads();
    sq = red[0][0] + red[0][1]; sk = red[1][0] + red[1][1];
    cq[(size_t)t * 1024 + c] = val[0] * rsqrtf(sq + EPS);
    ck[(size_t)t * 1024 + c] = val[1] * rsqrtf(sk + EPS);
    cv[(size_t)t * 1024 + c] = val[2];
    if (d == 0) {
        const float ga = proj[(size_t)t * DIN + OFF_GA + h], gb = proj[(size_t)t * DIN + OFF_GB + h];
        g[t * 8 + h] = -expf(a_log[h]) * softplusf_(ga + dt_bias[h]);
        beta[t * 8 + h] = sigmoidf_(gb);
    }
}

__global__ void __launch_bounds__(128) k_gdn_rec(const float* __restrict__ cq, const float* __restrict__ ck, const float* __restrict__ cv, const float* __restrict__ g, const float* __restrict__ beta,
                                                 const float* __restrict__ proj, const float* __restrict__ norm_w, float* __restrict__ oa) {
    const int h = blockIdx.x, d = threadIdx.x;
    __shared__ float kq[2][GD];
    __shared__ float red[2];
    float s[GD];
#pragma unroll
    for (int i = 0; i < GD; ++i) s[i] = 0.f;
    const float scale = 0.08838834764831845f;
    for (int t = 0; t < S; ++t) {
        __syncthreads();
        kq[0][d] = ck[(size_t)t * 1024 + h * GD + d]; kq[1][d] = cq[(size_t)t * 1024 + h * GD + d];
        __syncthreads();
        const float eg = expf(g[t * 8 + h]), b = beta[t * 8 + h], v = cv[(size_t)t * 1024 + h * GD + d];
        float ks = 0.f;
#pragma unroll
        for (int i = 0; i < GD; ++i) ks = fmaf(kq[0][i], s[i], ks);
        const float vn = b * (v - eg * ks);
        float o = 0.f;
#pragma unroll
        for (int i = 0; i < GD; ++i) { s[i] = fmaf(kq[0][i], vn, eg * s[i]); o = fmaf(kq[1][i], s[i], o); }
        o *= scale;
        float ss = wave_sum(o * o);
        if ((d & 63) == 0) red[d >> 6] = ss;
        __syncthreads();
        ss = red[0] + red[1];
        const float gz = proj[(size_t)t * DIN + OFF_GZ + h * GD + d];
        oa[(size_t)t * 1024 + h * GD + d] = o * rsqrtf(ss * (1.f / GD) + EPS) * norm_w[d] * siluf_(gz);
    }
}

__global__ void k_fox_cum(const float* __restrict__ proj, const float* __restrict__ fbias, float* __restrict__ cum) {
    const int h = threadIdx.x; if (h >= FH) return;
    float c = 0.f;
    for (int t = 0; t < S; ++t) { const float z = proj[(size_t)t * DIN + OFF_FF + h] + fbias[h]; c += -softplusf_(-z); cum[t * FH + h] = c; }
}

__global__ void __launch_bounds__(64) k_fox_attn(const float* __restrict__ proj, const float* __restrict__ cum, float* __restrict__ ob) {
    const int h = blockIdx.y, t = blockIdx.x * 64 + threadIdx.x, tmax = blockIdx.x * 64 + 63;
    float q[FD], o[FD];
#pragma unroll
    for (int i = 0; i < FD; ++i) { q[i] = proj[(size_t)t * DIN + OFF_FQ + h * FD + i] * 0.125f; o[i] = 0.f; }
    const float ct = cum[t * FH + h];
    float m = -INFINITY, l = 0.f;
    for (int s = 0; s <= tmax; ++s) {
        const float* kr = proj + (size_t)s * DIN + OFF_FK + h * FD;
        const float* vr = proj + (size_t)s * DIN + OFF_FV + h * FD;
        float sc = 0.f;
#pragma unroll
        for (int i = 0; i < FD; ++i) sc = fmaf(q[i], kr[i], sc);
        sc += ct - cum[s * FH + h];
        if (s <= t) {
            const float mn = fmaxf(m, sc), a = expf(m - mn), p = expf(sc - mn);
            l = l * a + p;
#pragma unroll
            for (int i = 0; i < FD; ++i) o[i] = fmaf(p, vr[i], o[i] * a);
            m = mn;
        }
    }
    const float il = 1.f / l;
#pragma unroll
    for (int i = 0; i < FD; ++i) { const float fo = proj[(size_t)t * DIN + OFF_FO + h * FD + i]; ob[(size_t)t * 1024 + h * FD + i] = o[i] * il * sigmoidf_(fo); }
}

__global__ void k_merge(const float* __restrict__ proj, const float* __restrict__ ya, const float* __restrict__ yb, float* __restrict__ y, int n) {
    const int i = blockIdx.x * blockDim.x + threadIdx.x; if (i >= n) return;
    const int t = i >> 10, c = i & 1023;
    y[i] = sigmoidf_(proj[(size_t)t * DIN + OFF_MGA + c]) * ya[i] + sigmoidf_(proj[(size_t)t * DIN + OFF_MGB + c]) * yb[i];
}
__global__ void k_swiglu(const float* __restrict__ gt, const float* __restrict__ up, float* __restrict__ hm, int n) {
    const int i = blockIdx.x * blockDim.x + threadIdx.x; if (i >= n) return;
    hm[i] = siluf_(gt[i]) * up[i];
}
}

extern "C" void kernel_launch(void* const* d_in, const int* in_sizes, int n_in, void* d_out, int out_size, void* d_ws, size_t ws_size, hipStream_t stream) {
    using namespace nv;
    const float* x = (const float*)d_in[0];
    const float* norm_mix_w = (const float*)d_in[1];
    const float* w_in = (const float*)d_in[2];
    const float* conv_w = (const float*)d_in[3];
    const float* a_log = (const float*)d_in[4];
    const float* dt_bias = (const float*)d_in[5];
    const float* gdn_norm_w = (const float*)d_in[6];
    const float* fox_f_bias = (const float*)d_in[7];
    const float* w_a = (const float*)d_in[8];
    const float* w_b = (const float*)d_in[9];
    const float* w_out = (const float*)d_in[10];
    const float* norm_ffn_w = (const float*)d_in[11];
    const float* w_gate = (const float*)d_in[12];
    const float* w_up = (const float*)d_in[13];
    const float* w_down = (const float*)d_in[14];
    const float* norm_final_w = (const float*)d_in[15];
    float* out = (float*)d_out;
    float* ws = (float*)d_ws;
    size_t off = 0;
    auto take = [&](size_t n) { float* p = ws + off; off += n; return p; };
    float* proj = take((size_t)S * DIN);
    float* hbuf = take((size_t)S * D);
    float* cq = take((size_t)S * D);
    float* ck = take((size_t)S * D);
    float* cv = hbuf;
    float* oa = take((size_t)S * D);
    float* ob = take((size_t)S * D);
    float* gg = take((size_t)S * 8);
    float* bb = take((size_t)S * 8);
    float* cum = take((size_t)S * 16);
    if (off * 4 > ws_size) { fprintf(stderr, "ws too small\n"); return; }
    for (int b = 0; b < B; ++b) {
        const float* xb = x + (size_t)b * S * D;
        float* outb = out + (size_t)b * S * D;
        float* x1 = outb;
        k_rmsnorm<<<S / 4, 256, 0, stream>>>(xb, norm_mix_w, hbuf, S);
        k_gemm<0><<<dim3((DIN + 63) / 64, S / 64), 256, 0, stream>>>(hbuf, D, w_in, DIN, proj, DIN, nullptr, S, DIN, D);
        k_gdn_pre<<<dim3(S, GH), 128, 0, stream>>>(proj, conv_w, a_log, dt_bias, cq, ck, cv, gg, bb);
        k_gdn_rec<<<GH, 128, 0, stream>>>(cq, ck, cv, gg, bb, proj, gdn_norm_w, oa);
        k_fox_cum<<<1, 64, 0, stream>>>(proj, fox_f_bias, cum);
        k_fox_attn<<<dim3(S / 64, FH), 64, 0, stream>>>(proj, cum, ob);
        k_gemm<0><<<dim3(D / 64, S / 64), 256, 0, stream>>>(oa, D, w_a, D, cq, D, nullptr, S, D, D);
        k_gemm<0><<<dim3(D / 64, S / 64), 256, 0, stream>>>(ob, D, w_b, D, ck, D, nullptr, S, D, D);
        k_merge<<<(S * D) / 256, 256, 0, stream>>>(proj, cq, ck, cv, S * D);
        k_gemm<1><<<dim3(D / 64, S / 64), 256, 0, stream>>>(cv, D, w_out, D, x1, D, xb, S, D, D);
        k_rmsnorm<<<S / 4, 256, 0, stream>>>(x1, norm_ffn_w, hbuf, S);
        float* gt = proj; float* up = proj + (size_t)S * FF; float* hm = proj + (size_t)2 * S * FF;
        k_gemm<0><<<dim3(FF / 64, S / 64), 256, 0, stream>>>(hbuf, D, w_gate, FF, gt, FF, nullptr, S, FF, D);
        k_gemm<0><<<dim3(FF / 64, S / 64), 256, 0, stream>>>(hbuf, D, w_up, FF, up, FF, nullptr, S, FF, D);
        k_swiglu<<<(S * FF) / 256, 256, 0, stream>>>(gt, up, hm, S * FF);
        k_gemm<1><<<dim3(D / 64, S / 64), 256, 0, stream>>>(hm, FF, w_down, D, oa, D, x1, S, D, FF);
        k_rmsnorm<<<S / 4, 256, 0, stream>>>(oa, norm_final_w, outb, S);
    }
}
```
